# Optimizing an MI355X kernel written in HIP

```python
import math
import jax, jax.numpy as jnp
from jax import lax
import numpy as np

D_MODEL = 1024
BATCH = 8
SEQ = 2048
DEPTH = 1

CHUNK = 64
N_META = 16
Q_BLOCK = 128

D_MIX = D_MODEL
D_POOL = D_MIX // 2
POOL_WINDOWS = (2, 4, 8, 16)
N_POOL_GROUPS = len(POOL_WINDOWS)
POOL_GROUP = D_POOL // N_POOL_GROUPS

N_HEADS = 4
QK_NOPE = 128
QK_ROPE = 64
V_HEAD = 128
D_ATTN = N_HEADS * V_HEAD
Q_LORA = 256
KV_LORA = 128
ROPE_THETA = 10000.0
EPS = 1e-6

SPLIT_POINTS = (D_POOL, 2 * D_POOL, 2 * D_POOL + Q_LORA,
                2 * D_POOL + Q_LORA + KV_LORA,
                2 * D_POOL + Q_LORA + KV_LORA + QK_ROPE)
D_IN = 2 * D_POOL + Q_LORA + KV_LORA + QK_ROPE + D_ATTN

kernel_name = "hymba_pool_mla_hybrid"


def rmsnorm(x, g):
    xf = x.astype(jnp.float32)
    y = xf * lax.rsqrt(jnp.mean(xf * xf, axis=-1, keepdims=True) + EPS)
    return y.astype(x.dtype) * g


def rope_tables(length):
    half = QK_ROPE // 2
    inv_freq = 1.0 / (ROPE_THETA ** (jnp.arange(half, dtype=jnp.float32) / half))
    ang = jnp.arange(length, dtype=jnp.float32)[:, None] * inv_freq[None, :]
    return jnp.cos(ang), jnp.sin(ang)


def apply_rope(x, cos, sin):
    cos = cos.astype(x.dtype)
    sin = sin.astype(x.dtype)
    x1, x2 = jnp.split(x, 2, axis=-1)
    return jnp.concatenate([x1 * cos - x2 * sin, x1 * sin + x2 * cos], axis=-1)


def pool_mixer(u, pool_w, pool_scale):
    B, L, _ = u.shape
    uf = u.astype(jnp.float32)
    groups = jnp.split(uf, N_POOL_GROUPS, axis=-1)
    count_max = jnp.arange(1, L + 1, dtype=jnp.float32)[None, :, None]
    outs = []
    for g, w in zip(groups, POOL_WINDOWS):
        c = jnp.cumsum(g, axis=1)
        c_prev = jnp.pad(c, ((0, 0), (w, 0), (0, 0)))[:, :L]
        mean = (c - c_prev) / jnp.minimum(count_max, float(w))
        outs.append(mean - g)
    pooled = jnp.stack(outs, axis=2).astype(u.dtype)
    mixed = jnp.einsum("blgc,gcd->blgd", pooled, pool_w)
    return mixed.reshape(B, L, D_POOL) * pool_scale


def _attend(qn, qr, q_ids, kn, kr, vv, k_ids):
    scale = (QK_NOPE + QK_ROPE) ** -0.5
    s = (jnp.einsum("bqhd,bkhd->bhqk", qn, kn, preferred_element_type=jnp.float32)
         + jnp.einsum("bqhd,bkd->bhqk", qr, kr, preferred_element_type=jnp.float32)) * scale
    mask = k_ids[None, :] <= q_ids[:, None]
    s = jnp.where(mask[None, None], s, jnp.finfo(jnp.float32).min)
    p = jax.nn.softmax(s, axis=-1).astype(vv.dtype)
    return jnp.einsum("bhqk,bkhd->bqhd", p, vv)


def mla_attention(q_nope, q_rope, k_nope, k_rope, v, chunk_id):
    B, L = q_nope.shape[0], q_nope.shape[1]
    n_blk = (L - N_META) // Q_BLOCK

    def blockify(t):
        t = t[:, N_META:]
        t = t.reshape((B, n_blk, Q_BLOCK) + t.shape[2:])
        return jnp.moveaxis(t, 1, 0)

    ids_b = chunk_id[N_META:].reshape(n_blk, Q_BLOCK)
    out_real = lax.map(
        lambda a: _attend(a[0], a[1], a[2], k_nope, k_rope, v, chunk_id),
        (blockify(q_nope), blockify(q_rope), ids_b))
    out_real = jnp.moveaxis(out_real, 0, 1).reshape(B, L - N_META, N_HEADS, V_HEAD)
    m_ids = chunk_id[:N_META]
    out_meta = _attend(q_nope[:, :N_META], q_rope[:, :N_META], m_ids,
                       k_nope[:, :N_META], k_rope[:, :N_META], v[:, :N_META], m_ids)
    return jnp.concatenate([out_meta, out_real], axis=1)


def hybrid_layer(h, cos, sin, chunk_id, norm_g, w_in, q_norm_g, w_q_b,
                 kv_norm_g, w_kv_b, pool_w, pool_scale, w_out):
    B, L, _ = h.shape
    u = rmsnorm(h, norm_g) @ w_in
    pool_in, pool_gate, c_q, c_kv, k_r, attn_gate = jnp.split(u, SPLIT_POINTS, axis=-1)

    pool_out = jax.nn.silu(pool_gate) * pool_mixer(pool_in, pool_w, pool_scale)

    q = (rmsnorm(c_q, q_norm_g) @ w_q_b).reshape(B, L, N_HEADS, QK_NOPE + QK_ROPE)
    q_nope = q[..., :QK_NOPE]
    q_rope = apply_rope(q[..., QK_NOPE:], cos[:, None, :], sin[:, None, :])
    kv = (rmsnorm(c_kv, kv_norm_g) @ w_kv_b).reshape(B, L, N_HEADS, QK_NOPE + V_HEAD)
    k_nope = kv[..., :QK_NOPE]
    v = kv[..., QK_NOPE:]
    k_rope = apply_rope(k_r, cos, sin)
    attn = mla_attention(q_nope, q_rope, k_nope, k_rope, v, chunk_id).reshape(B, L, D_ATTN)
    attn_out = jax.nn.silu(attn_gate) * attn

    mix = jnp.concatenate([pool_out, attn_out], axis=-1) @ w_out
    return h + mix


def setup_inputs(seed: int = 0) -> dict:
    key = jax.random.key(seed)
    ks = jax.random.split(key, 16)
    f32 = jnp.float32

    def nrm(k, shape, scale):
        return jax.random.normal(k, shape, f32) * scale

    return {
        "x": nrm(ks[0], (BATCH, SEQ, D_MODEL), 1.0),
        "meta_tokens": nrm(ks[1], (N_META, D_MODEL), 1.0),
        "norm_g": 1.0 + nrm(ks[2], (DEPTH, D_MODEL), 0.02),
        "w_in": nrm(ks[3], (DEPTH, D_MODEL, D_IN), D_MODEL ** -0.5),
        "q_norm_g": 1.0 + nrm(ks[4], (DEPTH, Q_LORA), 0.02),
        "w_q_b": nrm(ks[5], (DEPTH, Q_LORA, N_HEADS * (QK_NOPE + QK_ROPE)), Q_LORA ** -0.5),
        "kv_norm_g": 1.0 + nrm(ks[6], (DEPTH, KV_LORA), 0.02),
        "w_kv_b": nrm(ks[7], (DEPTH, KV_LORA, N_HEADS * (QK_NOPE + V_HEAD)), KV_LORA ** -0.5),
        "pool_w": nrm(ks[8], (DEPTH, N_POOL_GROUPS, POOL_GROUP, POOL_GROUP), POOL_GROUP ** -0.5),
        "pool_scale": 1.0 + nrm(ks[9], (DEPTH, D_POOL), 0.02),
        "w_out": nrm(ks[10], (DEPTH, D_MIX, D_MODEL), D_MIX ** -0.5),
        "final_norm_g": 1.0 + nrm(ks[11], (D_MODEL,), 0.02),
    }


def reference(x, meta_tokens, norm_g, w_in, q_norm_g, w_q_b, kv_norm_g, w_kv_b,
              pool_w, pool_scale, w_out, final_norm_g):
    B, S, D = x.shape
    L = S + N_META
    meta = jnp.broadcast_to(meta_tokens.astype(x.dtype)[None], (B, N_META, D))
    h = jnp.concatenate([meta, x], axis=1)
    chunk_id = jnp.concatenate([jnp.zeros((N_META,), jnp.int32),
                                1 + jnp.arange(S, dtype=jnp.int32) // CHUNK])
    cos, sin = rope_tables(L)
    for i in range(DEPTH):
        h = hybrid_layer(h, cos, sin, chunk_id, norm_g[i], w_in[i], q_norm_g[i], w_q_b[i],
                         kv_norm_g[i], w_kv_b[i], pool_w[i], pool_scale[i], w_out[i])
    return rmsnorm(h, final_norm_g)[:, N_META:]
```

```cpp
#include <hip/hip_runtime.h>
#include <cstdint>
#include <cstdio>

constexpr int BATCH = 8, SEQ = 2048, DM = 1024, NMETA = 16, DIN = 1984;
constexpr int R = BATCH * SEQ;
constexpr int RT = R + NMETA;
constexpr int NH = 4, QKN = 128, QKR = 64, VH = 128, QL = 256, KVL = 128, DPOOL = 512, DATT = 512;
constexpr int O_PIN = 0, O_PG = 512, O_CQ = 1024, O_CKV = 1280, O_KR = 1408, O_AG = 1472;
constexpr float EPS = 1e-6f;

typedef unsigned short bf16;
__device__ __forceinline__ unsigned f2bf(float f) { unsigned u = __builtin_bit_cast(unsigned, f); return (u + 0x7fffu + ((u >> 16) & 1u)) >> 16; }
__device__ __forceinline__ float bf2f(bf16 b) { return __builtin_bit_cast(float, ((unsigned)b) << 16); }
__device__ __forceinline__ float silu(float v) { return v / (1.f + __expf(-v)); }
__device__ __forceinline__ float wave_sum(float v) {
#pragma unroll
    for (int o = 1; o < 64; o <<= 1) v += __shfl_xor(v, o);
    return v;
}

constexpr size_t MiB = 1u << 20;
constexpr size_t WS_CTL = 0;
constexpr size_t WS_ROPE = 1 * MiB;
constexpr size_t WS_RSTD = 2 * MiB;
constexpr size_t WS_CQ = 32 * MiB;
constexpr size_t WS_KL = 41 * MiB;
constexpr size_t WS_ACT = 48 * MiB;
constexpr size_t WS_MIX = 97 * MiB;
constexpr size_t WS_SCR = 129 * MiB;
constexpr size_t WS_QF = WS_SCR, WS_KVF = WS_SCR + 52 * MiB;
constexpr size_t WS_END = 256 * MiB;

struct P {
    const float *x, *meta, *norm_g, *w_in, *q_norm_g, *w_q_b, *kv_norm_g, *w_kv_b, *pool_w, *pool_scale, *w_out, *final_g;
    float* out; unsigned char* ws;
};
__device__ __forceinline__ const float* row_src(const P& p, int r) { return r < R ? p.x + (size_t)r * DM : p.meta + (size_t)(r - R) * DM; }
__device__ __forceinline__ int row_pos(int r) { return r < R ? NMETA + (r % SEQ) : r - R; }

__global__ void __launch_bounds__(256) k_rope_table(P p) {
    float* cs = (float*)(p.ws + WS_ROPE); float* sn = cs + (SEQ + NMETA) * 32;
    const int i = blockIdx.x * blockDim.x + threadIdx.x; if (i >= (SEQ + NMETA) * 32) return;
    const int pos = i / 32, j = i % 32;
    const float inv = 1.0f / powf(10000.0f, (float)j / 32.0f);
    const float ang = (float)pos * inv;
    cs[i] = (float)cos((double)ang); sn[i] = (float)sin((double)ang);
}
__global__ void __launch_bounds__(256) k_rowstat(P p) {
    const int r = blockIdx.x * (blockDim.x / 64) + (threadIdx.x >> 6), lane = threadIdx.x & 63; if (r >= RT) return;
    const float* s = row_src(p, r); float a = 0.f;
    for (int k = lane; k < DM; k += 64) a += s[k] * s[k];
    a = wave_sum(a);
    if (lane == 0) ((float*)(p.ws + WS_RSTD))[r] = rsqrtf(a / DM + EPS);
}
__global__ void __launch_bounds__(256) k_gemm_in(P p) {
    __shared__ float As[16][65], Bs[16][65];
    const int tx = threadIdx.x & 15, ty = threadIdx.x >> 4, m0 = blockIdx.y * 64, n0 = blockIdx.x * 64;
    const float* rstd = (const float*)(p.ws + WS_RSTD); float* U = (float*)(p.ws + WS_SCR);
    float acc[4][4] = {};
    for (int k0 = 0; k0 < DM; k0 += 16) {
        for (int e = threadIdx.x; e < 64 * 16; e += 256) { const int m = e / 16, k = e % 16, r = m0 + m;
            As[k][m] = r < RT ? row_src(p, r)[k0 + k] * rstd[r] * p.norm_g[k0 + k] : 0.f; }
        for (int e = threadIdx.x; e < 16 * 64; e += 256) { const int k = e / 64, n = e % 64; Bs[k][n] = p.w_in[(size_t)(k0 + k) * DIN + n0 + n]; }
        __syncthreads();
#pragma unroll
        for (int k = 0; k < 16; ++k) {
            float a[4], b[4];
#pragma unroll
            for (int i = 0; i < 4; ++i) { a[i] = As[k][ty * 4 + i]; b[i] = Bs[k][tx * 4 + i]; }
#pragma unroll
            for (int i = 0; i < 4; ++i)
#pragma unroll
                for (int j = 0; j < 4; ++j) acc[i][j] += a[i] * b[j];
        }
        __syncthreads();
    }
    for (int i = 0; i < 4; ++i) { const int r = m0 + ty * 4 + i; if (r < RT) for (int j = 0; j < 4; ++j) U[(size_t)r * DIN + n0 + tx * 4 + j] = acc[i][j]; }
}
__global__ void __launch_bounds__(256) k_post_in(P p) {
    __shared__ float red[8];
    const int r = blockIdx.x, t = threadIdx.x;
    const float* u = (const float*)(p.ws + WS_SCR) + (size_t)r * DIN;
    bf16* CQ = (bf16*)(p.ws + WS_CQ) + (size_t)r * QL; bf16* KL = (bf16*)(p.ws + WS_KL) + (size_t)r * 192; bf16* ACT = (bf16*)(p.ws + WS_ACT) + (size_t)r * 1536;
    for (int c = t; c < 512; c += 256) { ACT[c] = (bf16)f2bf(u[O_PIN + c]); ACT[512 + c] = (bf16)f2bf(silu(u[O_PG + c])); ACT[1024 + c] = (bf16)f2bf(silu(u[O_AG + c])); }
    float v = u[O_CQ + t]; float s = wave_sum(v * v); if ((t & 63) == 0) red[t >> 6] = s; __syncthreads();
    float tot = red[0] + red[1] + red[2] + red[3]; __syncthreads();
    CQ[t] = (bf16)f2bf(v * rsqrtf(tot / QL + EPS) * p.q_norm_g[t]);
    float w = t < KVL ? u[O_CKV + t] : 0.f; s = wave_sum(w * w); if ((t & 63) == 0) red[t >> 6] = s; __syncthreads();
    tot = red[0] + red[1]; __syncthreads();
    if (t < KVL) KL[t] = (bf16)f2bf(w * rsqrtf(tot / KVL + EPS) * p.kv_norm_g[t]);
    if (t < 32) { const int pos = row_pos(r); const float* cs = (const float*)(p.ws + WS_ROPE); const float* sn = cs + (SEQ + NMETA) * 32;
        const float c = cs[pos * 32 + t], sv = sn[pos * 32 + t], x1 = u[O_KR + t], x2 = u[O_KR + 32 + t];
        KL[128 + t] = (bf16)f2bf(x1 * c - x2 * sv); KL[128 + 32 + t] = (bf16)f2bf(x1 * sv + x2 * c); }
}

__global__ void __launch_bounds__(256) k_qproj(P p) {
    const int n = blockIdx.x * blockDim.x + threadIdx.x, r = blockIdx.y; if (n >= 768) return;
    const bf16* cq = (const bf16*)(p.ws + WS_CQ) + (size_t)r * QL; float a = 0.f;
    for (int k = 0; k < QL; ++k) a += bf2f(cq[k]) * p.w_q_b[(size_t)k * 768 + n];
    ((float*)(p.ws + WS_QF))[(size_t)r * 768 + n] = a;
}
__global__ void __launch_bounds__(256) k_qrope(P p) {
    const int i = blockIdx.x * blockDim.x + threadIdx.x; if (i >= R * NH * 32) return;
    const int j = i % 32, h = (i / 32) % NH, r = i / (32 * NH), pos = row_pos(r);
    const float* cs = (const float*)(p.ws + WS_ROPE); const float* sn = cs + (SEQ + NMETA) * 32;
    float* q = (float*)(p.ws + WS_QF) + (size_t)r * 768 + h * 192 + 128;
    const float c = cs[pos * 32 + j], s = sn[pos * 32 + j], x1 = q[j], x2 = q[32 + j];
    q[j] = x1 * c - x2 * s; q[32 + j] = x1 * s + x2 * c;
}
__global__ void __launch_bounds__(256) k_kvproj(P p) {
    const int n = blockIdx.x * blockDim.x + threadIdx.x, r = blockIdx.y; if (n >= 1024) return;
    const bf16* kl = (const bf16*)(p.ws + WS_KL) + (size_t)r * 192; float a = 0.f;
    for (int k = 0; k < KVL; ++k) a += bf2f(kl[k]) * p.w_kv_b[(size_t)k * 1024 + n];
    ((float*)(p.ws + WS_KVF))[(size_t)r * 1024 + n] = a;
}
__global__ void __launch_bounds__(256) k_attn_naive(P p) {
    __shared__ float qs[4][192]; __shared__ float sc[4][SEQ + NMETA];
    const int r = blockIdx.x, h = threadIdx.x >> 6, lane = threadIdx.x & 63;
    const int b = r / SEQ, i = r % SEQ, nreal = 64 * (i / 64 + 1), nk = NMETA + nreal;
    const float* Qf = (const float*)(p.ws + WS_QF) + (size_t)r * 768 + h * 192; const float* KVf = (const float*)(p.ws + WS_KVF); const bf16* KL = (const bf16*)(p.ws + WS_KL);
    for (int d = lane; d < 192; d += 64) qs[h][d] = Qf[d];
    __syncthreads();
    float mx = -3.0e38f;
    for (int k = lane; k < nk; k += 64) { const int kr = k < NMETA ? R + k : b * SEQ + (k - NMETA);
        const float* kn = KVf + (size_t)kr * 1024 + h * 256; const bf16* kro = KL + (size_t)kr * 192 + 128; float s = 0.f;
        for (int d = 0; d < 128; ++d) s += qs[h][d] * kn[d];
        for (int d = 0; d < 64; ++d) s += qs[h][128 + d] * bf2f(kro[d]);
        s *= 0.07216878364870322f; sc[h][k] = s; mx = fmaxf(mx, s); }
#pragma unroll
    for (int o = 1; o < 64; o <<= 1) mx = fmaxf(mx, __shfl_xor(mx, o));
    float sum = 0.f;
    for (int k = lane; k < nk; k += 64) { const float e = __expf(sc[h][k] - mx); sc[h][k] = e; sum += e; }
    sum = wave_sum(sum);
    __syncthreads();
    const bf16* ACT = (const bf16*)(p.ws + WS_ACT) + (size_t)r * 1536; bf16* MIX = (bf16*)(p.ws + WS_MIX) + (size_t)r * 1024;
    for (int dv = lane; dv < 128; dv += 64) { float a = 0.f;
        for (int k = 0; k < nk; ++k) { const int kr = k < NMETA ? R + k : b * SEQ + (k - NMETA); a += sc[h][k] * KVf[(size_t)kr * 1024 + h * 256 + 128 + dv]; }
        a /= sum; MIX[512 + h * 128 + dv] = (bf16)f2bf(a * bf2f(ACT[1024 + h * 128 + dv])); }
}
__global__ void __launch_bounds__(512) k_pool_naive(P p) {
    __shared__ float pooled[512];
    const int r = blockIdx.x, c = threadIdx.x, b = r / SEQ, i = r % SEQ, g = c / 128, w = 2 << g;
    const bf16* ACT = (const bf16*)(p.ws + WS_ACT);
    float s = 0.f;
    for (int j = 0; j < w; ++j) { const int l = NMETA + i - j; const int rr = l >= NMETA ? b * SEQ + (l - NMETA) : R + l; s += bf2f(ACT[(size_t)rr * 1536 + c]); }
    pooled[c] = s / (float)w - bf2f(ACT[(size_t)r * 1536 + c]);
    __syncthreads();
    const int d = c % 128; float a = 0.f;
    for (int k = 0; k < 128; ++k) a += bf2f((bf16)f2bf(pooled[g * 128 + k])) * p.pool_w[((size_t)g * 128 + k) * 128 + d];
    a *= p.pool_scale[c];
    ((bf16*)(p.ws + WS_MIX))[(size_t)r * 1024 + c] = (bf16)f2bf(a * bf2f(ACT[(size_t)r * 1536 + 512 + c]));
}

__global__ void __launch_bounds__(256) k_out_naive(P p) {
    __shared__ float ms[8][1024]; __shared__ float red[8][4];
    const int r0 = blockIdx.x * 8, t = threadIdx.x;
    const bf16* MIX = (const bf16*)(p.ws + WS_MIX);
    for (int e = t; e < 8 * 1024; e += 256) ms[e / 1024][e % 1024] = bf2f(MIX[(size_t)(r0 + e / 1024) * 1024 + e % 1024]);
    __syncthreads();
    float acc[8][4] = {};
    for (int k = 0; k < 1024; ++k) { float wv[4];
#pragma unroll
        for (int j = 0; j < 4; ++j) wv[j] = p.w_out[(size_t)k * 1024 + t + 256 * j];
#pragma unroll
        for (int i = 0; i < 8; ++i) { const float m = ms[i][k];
#pragma unroll
            for (int j = 0; j < 4; ++j) acc[i][j] += m * wv[j]; } }
    for (int i = 0; i < 8; ++i) { float s = 0.f;
        for (int j = 0; j < 4; ++j) { acc[i][j] += p.x[(size_t)(r0 + i) * DM + t + 256 * j]; s += acc[i][j] * acc[i][j]; }
        s = wave_sum(s); if ((t & 63) == 0) red[i][t >> 6] = s; }
    __syncthreads();
    for (int i = 0; i < 8; ++i) { const float rs = rsqrtf((red[i][0] + red[i][1] + red[i][2] + red[i][3]) / DM + EPS);
        for (int j = 0; j < 4; ++j) p.out[(size_t)(r0 + i) * DM + t + 256 * j] = acc[i][j] * rs * p.final_g[t + 256 * j]; }
}

extern "C" void kernel_launch(void* const* d_in, const int* in_sizes, int n_in, void* d_out, int out_size, void* d_ws, size_t ws_size, hipStream_t stream) {
    if (n_in != 12 || out_size != R * DM || ws_size < WS_END) { fprintf(stderr, "kernel_launch: unexpected shapes (n_in %d out %d ws %zu)\n", n_in, out_size, ws_size); return; }
    P p{};
    p.x = (const float*)d_in[0]; p.meta = (const float*)d_in[1]; p.norm_g = (const float*)d_in[2]; p.w_in = (const float*)d_in[3]; p.q_norm_g = (const float*)d_in[4];
    p.w_q_b = (const float*)d_in[5]; p.kv_norm_g = (const float*)d_in[6]; p.w_kv_b = (const float*)d_in[7]; p.pool_w = (const float*)d_in[8]; p.pool_scale = (const float*)d_in[9];
    p.w_out = (const float*)d_in[10]; p.final_g = (const float*)d_in[11]; p.out = (float*)d_out; p.ws = (unsigned char*)d_ws;
    hipLaunchKernelGGL(k_rope_table, dim3(((SEQ + NMETA) * 32 + 255) / 256), dim3(256), 0, stream, p);
    hipLaunchKernelGGL(k_rowstat, dim3((RT + 3) / 4), dim3(256), 0, stream, p);
    hipLaunchKernelGGL(k_gemm_in, dim3(DIN / 64, (RT + 63) / 64), dim3(256), 0, stream, p);
    hipLaunchKernelGGL(k_post_in, dim3(RT), dim3(256), 0, stream, p);
    hipLaunchKernelGGL(k_qproj, dim3(3, R), dim3(256), 0, stream, p);
    hipLaunchKernelGGL(k_qrope, dim3(R * NH * 32 / 256), dim3(256), 0, stream, p);
    hipLaunchKernelGGL(k_kvproj, dim3(4, RT), dim3(256), 0, stream, p);
    hipLaunchKernelGGL(k_attn_naive, dim3(R), dim3(256), 0, stream, p);
    hipLaunchKernelGGL(k_pool_naive, dim3(R), dim3(512), 0, stream, p);
    hipLaunchKernelGGL(k_out_naive, dim3(R / 8), dim3(256), 0, stream, p);
}
```
